# Optimizing an MI355X kernel written in HIP

```python
import math
import jax, jax.numpy as jnp
from jax import lax
import numpy as np

D_MODEL = 1024
BATCH = 4
SEQ = 8192
DEPTH = 1
DEC_BATCH = 16
DEC_SEQ = 64
PAST_LEN = 2048

CHUNK = 64
Q_BLOCK = 128
MIX_WIDTH = D_MODEL
ATTN_WIDTH = MIX_WIDTH // 2
CONV_WIDTH = MIX_WIDTH - ATTN_WIDTH
N_HEADS = 4
HEAD_V = ATTN_WIDTH // N_HEADS
HEAD_QK = HEAD_V // 2
CONV_K = 3
D_FF = 4 * D_MODEL
N_BUCKETS = 32
MAX_DISTANCE = 128
LN_EPS = 1e-5
SUBLN_EPS = 1e-5
DN_ALPHA = (2.0 * DEPTH) ** 0.25
DN_BETA = (8.0 * DEPTH) ** -0.25
IN_WIDTH = 3 * ATTN_WIDTH + 3 * CONV_WIDTH

kernel_name = "hybrid_diffattn_shortconv_stream_step"


def _lambda_init(layer):
    return 0.8 - 0.6 * math.exp(-0.3 * layer)


def layer_norm(x, g, b):
    xf = x.astype(jnp.float32)
    mu = jnp.mean(xf, axis=-1, keepdims=True)
    var = jnp.mean(jnp.square(xf - mu), axis=-1, keepdims=True)
    return ((xf - mu) * lax.rsqrt(var + LN_EPS) * g + b).astype(x.dtype)


def rms_norm(x, g):
    xf = x.astype(jnp.float32)
    return xf * lax.rsqrt(jnp.mean(jnp.square(xf), axis=-1, keepdims=True) + SUBLN_EPS) * g


def rel_bucket(rel):
    half = N_BUCKETS // 2
    max_exact = half // 2
    ret = jnp.where(rel > 0, half, 0)
    n = jnp.abs(rel)
    nf = jnp.maximum(n, 1).astype(jnp.float32)
    large = max_exact + (jnp.log(nf / max_exact) / math.log(MAX_DISTANCE / max_exact)
                         * (half - max_exact)).astype(jnp.int32)
    large = jnp.minimum(large, half - 1)
    return ret + jnp.where(n < max_exact, n, large)


def diff_attention(q, k, v, q_pos, k_pos, rel_bias, lam):
    scale = HEAD_QK ** -0.5
    bias = jnp.transpose(rel_bias[rel_bucket(k_pos[None, :] - q_pos[:, None])], (2, 0, 1)).astype(jnp.float32)
    visible = (k_pos[None, :] // CHUNK) <= (q_pos[:, None] // CHUNK)

    def probs(qi, ki):
        s = jnp.einsum('bqhd,bkhd->bhqk', qi, ki, preferred_element_type=jnp.float32) * scale + bias
        return jax.nn.softmax(jnp.where(visible, s, -jnp.inf), axis=-1)

    p = probs(q[..., :HEAD_QK], k[..., :HEAD_QK]) - lam * probs(q[..., HEAD_QK:], k[..., HEAD_QK:])
    return jnp.einsum('bhqk,bkhd->bqhd', p.astype(v.dtype), v, preferred_element_type=jnp.float32)


def prompt_attention(q, k, v, rel_bias, lam):
    b, s = q.shape[0], q.shape[1]
    nb = s // Q_BLOCK
    qb = jnp.moveaxis(q.reshape(b, nb, Q_BLOCK, N_HEADS, HEAD_V), 1, 0)
    k_pos = jnp.arange(s, dtype=jnp.int32)

    def one_block(args):
        q_blk, i = args
        q_pos = i * Q_BLOCK + jnp.arange(Q_BLOCK, dtype=jnp.int32)
        return diff_attention(q_blk, k, v, q_pos, k_pos, rel_bias, lam)

    out = lax.map(one_block, (qb, jnp.arange(nb, dtype=jnp.int32)))
    return jnp.moveaxis(out, 0, 1).reshape(b, s, N_HEADS, HEAD_V)


def project_in(x, w_in):
    z = jnp.einsum('btd,de->bte', x, w_in)
    a, c = ATTN_WIDTH, CONV_WIDTH
    q, k, v, gb, gc, h = jnp.split(z, [a, 2 * a, 3 * a, 3 * a + c, 3 * a + 2 * c], axis=-1)
    bsz, t = x.shape[0], x.shape[1]
    heads = lambda y: y.reshape(bsz, t, N_HEADS, HEAD_V)
    return heads(q), heads(k), heads(v), gb, gc, h


def causal_conv(u_ext, w):
    t = u_ext.shape[1] - (CONV_K - 1)
    return sum(u_ext[:, j:j + t] * w[j] for j in range(CONV_K))


def finish(x, attn, conv, subln_g, lam_init, w_out, ln1_g, ln1_b, w_ff1, w_ff2, ln2_g, ln2_b):
    bsz, t = x.shape[0], x.shape[1]
    a = (rms_norm(attn, subln_g) * (1.0 - lam_init)).reshape(bsz, t, ATTN_WIDTH).astype(x.dtype)
    y = jnp.einsum('bte,ed->btd', jnp.concatenate([a, conv.astype(x.dtype)], axis=-1), w_out)
    x = layer_norm(DN_ALPHA * x + y, ln1_g, ln1_b)
    hdn = jnp.square(jax.nn.relu(jnp.einsum('btd,df->btf', x, w_ff1)))
    return layer_norm(DN_ALPHA * x + jnp.einsum('btf,fd->btd', hdn, w_ff2), ln2_g, ln2_b)


def setup_inputs(seed: int = 0) -> dict:
    key = jax.random.key(seed)
    ks = jax.random.split(key, 32)
    f32 = jnp.float32
    nrm = lambda k, shape, s: jax.random.normal(k, shape, f32) * s
    sd = D_MODEL ** -0.5
    w_in = jnp.concatenate([
        nrm(ks[0], (DEPTH, D_MODEL, ATTN_WIDTH), sd),
        nrm(ks[1], (DEPTH, D_MODEL, ATTN_WIDTH), sd),
        nrm(ks[2], (DEPTH, D_MODEL, ATTN_WIDTH), sd * DN_BETA),
        nrm(ks[3], (DEPTH, D_MODEL, CONV_WIDTH), sd),
        nrm(ks[4], (DEPTH, D_MODEL, CONV_WIDTH), sd),
        nrm(ks[5], (DEPTH, D_MODEL, CONV_WIDTH), sd * DN_BETA),
    ], axis=-1)
    return {
        "x_prompt": nrm(ks[6], (BATCH, SEQ, D_MODEL), 1.0),
        "x_sample": nrm(ks[7], (DEC_BATCH, DEC_SEQ, D_MODEL), 1.0),
        "cache_k": nrm(ks[8], (DEPTH, DEC_BATCH, PAST_LEN, N_HEADS, HEAD_V), 1.0),
        "cache_v": nrm(ks[9], (DEPTH, DEC_BATCH, PAST_LEN, N_HEADS, HEAD_V), DN_BETA),
        "cache_conv": nrm(ks[10], (DEPTH, DEC_BATCH, CONV_K - 1, CONV_WIDTH), DN_BETA),
        "ln0_g": 1.0 + nrm(ks[11], (D_MODEL,), 0.02),
        "ln0_b": nrm(ks[12], (D_MODEL,), 0.02),
        "rel_bias": nrm(ks[13], (N_BUCKETS, N_HEADS), 0.5),
        "w_in": w_in,
        "conv_w": nrm(ks[14], (DEPTH, CONV_K, CONV_WIDTH), CONV_K ** -0.5),
        "lambda_q1": nrm(ks[15], (DEPTH, HEAD_QK), 0.1),
        "lambda_k1": nrm(ks[16], (DEPTH, HEAD_QK), 0.1),
        "lambda_q2": nrm(ks[17], (DEPTH, HEAD_QK), 0.1),
        "lambda_k2": nrm(ks[18], (DEPTH, HEAD_QK), 0.1),
        "subln_g": 1.0 + nrm(ks[19], (DEPTH, HEAD_V), 0.02),
        "w_out": nrm(ks[20], (DEPTH, MIX_WIDTH, D_MODEL), MIX_WIDTH ** -0.5 * DN_BETA),
        "ln1_g": 1.0 + nrm(ks[21], (DEPTH, D_MODEL), 0.02),
        "ln1_b": nrm(ks[22], (DEPTH, D_MODEL), 0.02),
        "w_ff1": nrm(ks[23], (DEPTH, D_MODEL, D_FF), sd * DN_BETA),
        "w_ff2": nrm(ks[24], (DEPTH, D_FF, D_MODEL), D_FF ** -0.5 * DN_BETA),
        "ln2_g": 1.0 + nrm(ks[25], (DEPTH, D_MODEL), 0.02),
        "ln2_b": nrm(ks[26], (DEPTH, D_MODEL), 0.02),
    }


def reference(x_prompt, x_sample, cache_k, cache_v, cache_conv, ln0_g, ln0_b, rel_bias, w_in, conv_w,
              lambda_q1, lambda_k1, lambda_q2, lambda_k2, subln_g, w_out, ln1_g, ln1_b,
              w_ff1, w_ff2, ln2_g, ln2_b):
    f32 = jnp.float32
    xp = layer_norm(x_prompt, ln0_g, ln0_b)
    xs = layer_norm(x_sample, ln0_g, ln0_b)
    past = cache_k.shape[2]
    t_s = x_sample.shape[1]
    q_pos_s = past + jnp.arange(t_s, dtype=jnp.int32)
    k_pos_s = jnp.arange(past + t_s, dtype=jnp.int32)
    kp_l, vp_l, cp_l, ks_l, vs_l, cs_l = [], [], [], [], [], []
    for l in range(DEPTH):
        lam_init = _lambda_init(l)
        lam = (jnp.exp(jnp.sum(lambda_q1[l].astype(f32) * lambda_k1[l].astype(f32)))
               - jnp.exp(jnp.sum(lambda_q2[l].astype(f32) * lambda_k2[l].astype(f32))) + lam_init)
        ffn_args = (subln_g[l], lam_init, w_out[l], ln1_g[l], ln1_b[l], w_ff1[l], w_ff2[l], ln2_g[l], ln2_b[l])

        q, k, v, gb, gc, h = project_in(xp, w_in[l])
        attn = prompt_attention(q, k, v, rel_bias, lam)
        u_ext = jnp.pad(gc * h, ((0, 0), (CONV_K - 1, 0), (0, 0)))
        conv = gb * causal_conv(u_ext, conv_w[l])
        kp_l.append(k)
        vp_l.append(v)
        cp_l.append(u_ext[:, -(CONV_K - 1):])
        xp = finish(xp, attn, conv, *ffn_args)

        q, k, v, gb, gc, h = project_in(xs, w_in[l])
        k_all = jnp.concatenate([cache_k[l].astype(k.dtype), k], axis=1)
        v_all = jnp.concatenate([cache_v[l].astype(v.dtype), v], axis=1)
        attn = diff_attention(q, k_all, v_all, q_pos_s, k_pos_s, rel_bias, lam)
        u_ext = jnp.concatenate([cache_conv[l].astype(h.dtype), gc * h], axis=1)
        conv = gb * causal_conv(u_ext, conv_w[l])
        ks_l.append(k)
        vs_l.append(v)
        cs_l.append(u_ext[:, -(CONV_K - 1):])
        xs = finish(xs, attn, conv, *ffn_args)

    return (xp, xs, jnp.stack(kp_l), jnp.stack(vp_l), jnp.stack(cp_l),
            jnp.stack(ks_l), jnp.stack(vs_l), jnp.stack(cs_l))
```

```cpp
#include <hip/hip_runtime.h>
#include <hip/hip_bf16.h>
#include <cstdio>
#include <cstdint>

#ifndef MK_N_LAUNCHES
#define MK_N_LAUNCHES 8
#endif

constexpr int DM = 1024, NPROMPT = 4 * 8192, NSAMP = 16 * 64, M = NPROMPT + NSAMP;
constexpr int SEQ = 8192, PAST = 2048, DSEQ = 64, KVS_ROWS = 2176;
constexpr int NKV_ROWS = NPROMPT + 16 * KVS_ROWS;
constexpr int NIN = 3072, DFF = 4096;
constexpr float LN_EPS = 1e-5f, SUBLN_EPS = 1e-5f;
constexpr float DN_ALPHA = 1.189207115002721f;
constexpr float LAM_INIT = 0.2f;
constexpr float C2 = 0.125f * 1.4426950408889634f;
constexpr size_t O_Y = 0, O_NKP = 34603008, O_NVP = 51380224, O_NCP = 68157440, O_NKS = 68161536, O_NVS = 68685824, O_NCS = 69210112;
namespace pg8 {
#define PG8_LAS __attribute__((address_space(3)))
typedef unsigned short bf16_t;
typedef short bf16x8 __attribute__((ext_vector_type(8)));
typedef float f32x4 __attribute__((ext_vector_type(4)));
typedef unsigned u32x4 __attribute__((ext_vector_type(4)));
constexpr int BM = 256, BK = 64, HALF = 128, HTB = HALF * BK * 2  , STAGE_BYTES = 8 * HTB, NXCD = 8, WGM = 8;

__host__ __device__ __forceinline__ int lds_byte(int r, int c) { const int st = (r >> 4) * 2 + (c >> 5), rr = r & 15, cc = c & 31, ob = rr * 64 + cc * 2; return st * 1024 + (ob ^ (((ob >> 9) & 1) << 5)); }
__host__ __device__ __forceinline__ void stage_rc(int b, int& R, int& C) { const int st = b / 1024, sb = b % 1024, swz = sb ^ (((sb >> 9) & 1) << 5); R = (st >> 1) * 16 + swz / 64; C = (st & 1) * 32 + (swz % 64) / 2; }
__host__ __device__ __forceinline__ int perm32(int rho) { const int n = rho >> 4, i = rho & 15; return 8 * (i >> 2) + 4 * n + (i & 3); }

struct Unit { int pm, pn; };
struct Gemm { const bf16_t* A; const bf16_t* Bt; int M, N, K; };

struct StaticOrder {
    int nM, nN, nwg, G, c;
    __host__ __device__ void init(int M, int N, int G_, int c_) { nM = M / BM; nN = N / BM; nwg = nM * nN; G = G_; c = c_; }
    __host__ __device__ bool next(int i, Unit& u) const {
        const long L = (long)i * G + c; if (L >= nwg) return false;
        int wgid = (int)L; { const int q = nwg / NXCD, r = nwg % NXCD, xcd = wgid % NXCD, off = wgid / NXCD; wgid = (xcd < r ? xcd * (q + 1) : r * (q + 1) + (xcd - r) * q) + off; }
        const int nig = WGM * nN, gid = wgid / nig, fm = gid * WGM, gsz = (nM - fm) < WGM ? (nM - fm) : WGM;
        u.pm = fm + ((wgid % nig) % gsz); u.pn = (wgid % nig) / gsz; return true;
    }
    __device__ __forceinline__ void a_ready(const Unit&) const {}
    __device__ __forceinline__ void done(const Unit&) const {}
};

__device__ __forceinline__ unsigned cvt_pk_bf16(float lo, float hi) { unsigned r; asm volatile("v_cvt_pk_bf16_f32 %0, %1, %2" : "=v"(r) : "v"(lo), "v"(hi)); return r; }
typedef float f32x2 __attribute__((ext_vector_type(2)));
__device__ __forceinline__ u32x4 pack8(f32x4 v0, f32x4 v1) { u32x4 w; w.x = cvt_pk_bf16(v0[0], v0[1]); w.y = cvt_pk_bf16(v0[2], v0[3]); w.z = cvt_pk_bf16(v1[0], v1[1]); w.w = cvt_pk_bf16(v1[2], v1[3]); return w; }

struct EpiIn {
    static constexpr bool PERM = true, AFTER_DRAIN = false;
    bf16_t *QB, *KB, *VB, *GB, *UB; float* out;
    __device__ __forceinline__ void operator()(const f32x4 (&acc)[2][2][4][2], const Unit& u, int wr, int wc, int fr, int fq) const {
        const int rowb = u.pm * BM + wr * 64 + fr; const bool samp = u.pm >= (NPROMPT / BM); const int pn = u.pn;
        if (pn < 8) {
            const int kind = pn >> 1; const int colb = (pn & 1) * 256 + wc * 32 + 8 * fq;
            bf16_t* const bbase = kind == 0 ? QB : kind == 1 ? KB : kind == 2 ? VB : GB;
#pragma unroll
            for (int ai = 0; ai < 2; ++ai)
#pragma unroll
                for (int m = 0; m < 4; ++m) {
                    const int row = rowb + ai * HALF + m * 16; size_t drow = (size_t)row; float* fp = nullptr;
                    if (kind == 1 || kind == 2) {
                        if (samp) { const int rs = row - NPROMPT; drow = (size_t)(NPROMPT + (rs >> 6) * KVS_ROWS + PAST + (rs & 63));
                                    fp = out + (kind == 1 ? O_NKS : O_NVS) + (size_t)rs * 512 + colb; }
                        else fp = out + (kind == 1 ? O_NKP : O_NVP) + (size_t)row * 512 + colb;
                    }
                    bf16_t* bp = bbase + drow * 512 + colb;
#pragma unroll
                    for (int bj = 0; bj < 2; ++bj) { f32x4 v0 = acc[ai][bj][m][0], v1 = acc[ai][bj][m][1];
                        if (kind == 1 || kind == 2) { *(f32x4*)(fp + bj * HALF) = v0; *(f32x4*)(fp + bj * HALF + 4) = v1; }
                        if (kind == 0) { v0 = v0 * C2; v1 = v1 * C2; }
                        *(u32x4*)(bp + bj * HALF) = pack8(v0, v1); }
                }
        } else {
            const int ch = (pn - 8) * 128 + wc * 32 + 8 * fq;
#pragma unroll
            for (int ai = 0; ai < 2; ++ai)
#pragma unroll
                for (int m = 0; m < 4; ++m) {
                    const int row = rowb + ai * HALF + m * 16;
                    const f32x4 u0 = acc[ai][0][m][0] * acc[ai][1][m][0], u1 = acc[ai][0][m][1] * acc[ai][1][m][1];
                    *(u32x4*)(UB + (size_t)row * 512 + ch) = pack8(u0, u1);
                    if (samp) { const int rs = row - NPROMPT; const int t = rs & 63; if (t >= 62) { float* fp = out + O_NCS + (size_t)((rs >> 6) * 2 + (t - 62)) * 512 + ch; *(f32x4*)fp = u0; *(f32x4*)(fp + 4) = u1; } }
                    else { const int t = row & (SEQ - 1); if (t >= SEQ - 2) { float* fp = out + O_NCP + (size_t)((row >> 13) * 2 + (t - (SEQ - 2))) * 512 + ch; *(f32x4*)fp = u0; *(f32x4*)(fp + 4) = u1; } }
                }
        }
    }
};

struct EpiOut {
    static constexpr bool PERM = true, AFTER_DRAIN = false;
    const float *xp, *xs; const float* stats; const float *g0, *b0; float* Y;
    __device__ __forceinline__ void operator()(const f32x4 (&acc)[2][2][4][2], const Unit& u, int wr, int wc, int fr, int fq) const {
        const int rowb = u.pm * BM + wr * 64 + fr; const bool samp = u.pm >= (NPROMPT / BM);
        const int colb = u.pn * BM + wc * 32 + 8 * fq;
        f32x4 gv[2][2], bv[2][2];
#pragma unroll
        for (int bj = 0; bj < 2; ++bj)
#pragma unroll
            for (int n = 0; n < 2; ++n) { gv[bj][n] = *(const f32x4*)(g0 + colb + bj * HALF + 4 * n) * DN_ALPHA; bv[bj][n] = *(const f32x4*)(b0 + colb + bj * HALF + 4 * n) * DN_ALPHA; }
#pragma unroll
        for (int ai = 0; ai < 2; ++ai)
#pragma unroll
            for (int m = 0; m < 4; ++m) {
                const int row = rowb + ai * HALF + m * 16;
                const float* xr = (samp ? xs + (size_t)(row - NPROMPT) * DM : xp + (size_t)row * DM) + colb;
                const float mean = stats[2 * row], rstd = stats[2 * row + 1];
                float* yp = Y + (size_t)row * DM + colb;
#pragma unroll
                for (int bj = 0; bj < 2; ++bj)
#pragma unroll
                    for (int n = 0; n < 2; ++n) { const f32x4 xv = *(const f32x4*)(xr + bj * HALF + 4 * n);
                        *(f32x4*)(yp + bj * HALF + 4 * n) = ((xv - mean) * rstd) * gv[bj][n] + bv[bj][n] + acc[ai][bj][m][n]; }
            }
    }
};

struct EpiRelu2 {
    static constexpr bool PERM = true, AFTER_DRAIN = false;
    bf16_t* O; int ldc;
    __device__ __forceinline__ void operator()(const f32x4 (&acc)[2][2][4][2], const Unit& u, int wr, int wc, int fr, int fq) const {
        const int rowb = u.pm * BM + wr * 64 + fr; const int colb = u.pn * BM + wc * 32 + 8 * fq;
#pragma unroll
        for (int ai = 0; ai < 2; ++ai)
#pragma unroll
            for (int m = 0; m < 4; ++m) { bf16_t* rowp = O + (size_t)(rowb + ai * HALF + m * 16) * ldc + colb;
#pragma unroll
                for (int bj = 0; bj < 2; ++bj) { f32x4 v0 = acc[ai][bj][m][0], v1 = acc[ai][bj][m][1];
#pragma unroll
                    for (int i = 0; i < 4; ++i) { const float a = fmaxf(v0[i], 0.f), b = fmaxf(v1[i], 0.f); v0[i] = a * a; v1[i] = b * b; }
                    *(u32x4*)(rowp + bj * HALF) = pack8(v0, v1); } }
    }
};

struct EpiDown {
    static constexpr bool PERM = true, AFTER_DRAIN = false;
    float* Y;
    __device__ __forceinline__ void operator()(const f32x4 (&acc)[2][2][4][2], const Unit& u, int wr, int wc, int fr, int fq) const {
        const int rowb = u.pm * BM + wr * 64 + fr; const int colb = u.pn * BM + wc * 32 + 8 * fq;
#pragma unroll
        for (int ai = 0; ai < 2; ++ai)
#pragma unroll
            for (int m = 0; m < 4; ++m) { float* yp = Y + (size_t)(rowb + ai * HALF + m * 16) * DM + colb;
#pragma unroll
                for (int bj = 0; bj < 2; ++bj)
#pragma unroll
                    for (int n = 0; n < 2; ++n) { const f32x4 xv = *(const f32x4*)(yp + bj * HALF + 4 * n); *(f32x4*)(yp + bj * HALF + 4 * n) = xv * DN_ALPHA + acc[ai][bj][m][n]; } }
    }
};
template <class Epi, class Sched, bool ALIGN_EPI = false, bool SP2 = false>
__device__ __forceinline__ void gemm_phase(PG8_LAS unsigned char* lds, const Gemm g, const Sched& S, const Epi& E) {
    const int tid = threadIdx.x, wid = __builtin_amdgcn_readfirstlane(tid >> 6), lane = tid & 63, wr = wid >> 2, wc = wid & 3, fr = lane & 15, fq = lane >> 4;
    const int K = g.K, nt = K / BK;
    unsigned voffA[2], voffB[2];
#pragma unroll
    for (int i = 0; i < 2; ++i) { int R, C; stage_rc(tid * 16 + i * 8192, R, C); const int Rb = Epi::PERM ? ((R & ~31) + perm32(R & 31)) : R;
        voffA[i] = (unsigned)(R * K + C) * 2u; voffB[i] = (unsigned)(Rb * K + C) * 2u; }
    const size_t kstep = (size_t)(BK * 2);
    const size_t hstep = (size_t)HALF * K * 2;
    const size_t tstep = 2 * hstep;
    const unsigned ldsw = (unsigned)wid * 1024u;
    const int aoff = lds_byte(wr * 64 + fr, fq * 8), boff = lds_byte(wc * 32 + fr, fq * 8);
#define PG8_SA(b, h) (((b) * 2 + (h)) * HTB)
#define PG8_SB(b, h) ((4 + (b) * 2 + (h)) * HTB)
#define PG8_STAGE(bufoff, gbase, voff) do { _Pragma("unroll") for (int _i = 0; _i < 2; ++_i) \
        __builtin_amdgcn_global_load_lds((const unsigned*)((const char*)(gbase) + (voff)[_i]), (PG8_LAS unsigned*)(lds + (bufoff) + ldsw + _i * 8192), 16, 0, 0); } while (0)
#define PG8_LDA(dst, b, h) do { _Pragma("unroll") for (int m = 0; m < 4; ++m) _Pragma("unroll") for (int k = 0; k < 2; ++k) dst[m][k] = *(const PG8_LAS bf16x8*)(lds + PG8_SA(b, h) + aoff + m * 2048 + k * 1024); } while (0)
#define PG8_LDB(dst, b, h) do { _Pragma("unroll") for (int n = 0; n < 2; ++n) _Pragma("unroll") for (int k = 0; k < 2; ++k) dst[n][k] = *(const PG8_LAS bf16x8*)(lds + PG8_SB(b, h) + boff + n * 2048 + k * 1024); } while (0)
#define PG8_MMA(ai, bj, At, Bt) do { __builtin_amdgcn_s_setprio(1); _Pragma("unroll") for (int m = 0; m < 4; ++m) _Pragma("unroll") for (int n = 0; n < 2; ++n) _Pragma("unroll") for (int k = 0; k < 2; ++k) \
        acc[ai][bj][m][n] = __builtin_amdgcn_mfma_f32_16x16x32_bf16(Bt[n][k], At[m][k], acc[ai][bj][m][n], 0, 0, 0); __builtin_amdgcn_s_setprio(0); } while (0)
#define PG8_WAIT_V(n) asm volatile("s_waitcnt vmcnt(" #n ")" ::: "memory")
#define PG8_WAIT_L(n) asm volatile("s_waitcnt lgkmcnt(" #n ")" ::: "memory")
#define PG8_BAR __builtin_amdgcn_s_barrier()
#define PG8_SCHED __builtin_amdgcn_sched_barrier(0)
    Unit cur, nxt; int ui = 0;
    if (!S.next(0, cur)) return;
    f32x4 acc[2][2][4][2];
#pragma unroll
    for (int a = 0; a < 2; ++a)
#pragma unroll
        for (int b = 0; b < 2; ++b)
#pragma unroll
            for (int m = 0; m < 4; ++m)
#pragma unroll
                for (int n = 0; n < 2; ++n) acc[a][b][m][n] = (f32x4){0.f, 0.f, 0.f, 0.f};
    bf16x8 At[4][2], B0[2][2], B1[2][2];
    const char* cA = (const char*)g.A + (size_t)cur.pm * tstep; const char* cB = (const char*)g.Bt + (size_t)cur.pn * tstep;
    S.a_ready(cur);
    if constexpr (SP2) {
        PG8_STAGE(PG8_SB(0, 0), cB, voffB); PG8_STAGE(PG8_SB(0, 1), cB + hstep, voffB); PG8_STAGE(PG8_SA(0, 0), cA, voffA); PG8_STAGE(PG8_SA(0, 1), cA + hstep, voffA);
        if (wr == 1) PG8_BAR;
        PG8_WAIT_V(2); PG8_BAR;
        PG8_STAGE(PG8_SB(1, 0), cB + kstep, voffB); PG8_STAGE(PG8_SA(1, 0), cA + kstep, voffA); PG8_STAGE(PG8_SB(1, 1), cB + hstep + kstep, voffB);
        PG8_WAIT_V(6); PG8_BAR;
    } else {
        PG8_STAGE(PG8_SB(0, 0), cB, voffB); PG8_STAGE(PG8_SA(0, 0), cA, voffA); PG8_STAGE(PG8_SB(0, 1), cB + hstep, voffB); PG8_STAGE(PG8_SA(0, 1), cA + hstep, voffA);
        if (wr == 1) PG8_BAR;
        PG8_WAIT_V(4); PG8_BAR;
        PG8_STAGE(PG8_SB(1, 0), cB + kstep, voffB); PG8_STAGE(PG8_SA(1, 0), cA + kstep, voffA); PG8_STAGE(PG8_SB(1, 1), cB + hstep + kstep, voffB);
        PG8_WAIT_V(6); PG8_BAR;
    }
    for (;;) {
        const bool has_next = S.next(ui + 1, nxt);
        const char* nA = has_next ? (const char*)g.A + (size_t)nxt.pm * tstep : cA; const char* nB = has_next ? (const char*)g.Bt + (size_t)nxt.pn * tstep : cB;
        for (int t = 0; t < nt; t += 2) {
            const bool last = (t == nt - 2);
            const char* a1 = cA + (size_t)(t + 1) * kstep;
            const char* a2 = last ? nA : cA + (size_t)(t + 2) * kstep; const char* b2 = last ? nB : cB + (size_t)(t + 2) * kstep;
            const char* a3 = a2 + kstep; const char* b3 = b2 + kstep;
            if (last && has_next) S.a_ready(nxt);
            if constexpr (SP2) {
            PG8_LDB(B0, 0, 0); PG8_LDB(B1, 0, 1); PG8_SCHED; PG8_LDA(At, 0, 0); PG8_STAGE(PG8_SA(1, 1), a1 + hstep, voffA);
            PG8_WAIT_V(8); PG8_WAIT_L(0); PG8_BAR; PG8_MMA(0, 0, At, B0); PG8_MMA(0, 1, At, B1); PG8_BAR; PG8_SCHED;
            PG8_LDA(At, 0, 1); PG8_STAGE(PG8_SB(0, 0), b2, voffB); PG8_STAGE(PG8_SB(0, 1), b2 + hstep, voffB); PG8_STAGE(PG8_SA(0, 0), a2, voffA);
            PG8_WAIT_V(8); PG8_WAIT_L(0); PG8_BAR; PG8_MMA(1, 0, At, B0); PG8_MMA(1, 1, At, B1); PG8_BAR; PG8_SCHED;
            PG8_LDB(B0, 1, 0); PG8_LDB(B1, 1, 1); PG8_SCHED; PG8_LDA(At, 1, 0); PG8_STAGE(PG8_SA(0, 1), a2 + hstep, voffA);
            PG8_WAIT_V(8); PG8_WAIT_L(0); PG8_BAR; PG8_MMA(0, 0, At, B0); PG8_MMA(0, 1, At, B1); PG8_BAR; PG8_SCHED;
            PG8_LDA(At, 1, 1); PG8_STAGE(PG8_SB(1, 0), b3, voffB); PG8_STAGE(PG8_SB(1, 1), b3 + hstep, voffB); PG8_STAGE(PG8_SA(1, 0), a3, voffA);
            PG8_WAIT_V(8); PG8_WAIT_L(0); PG8_BAR; PG8_MMA(1, 0, At, B0); PG8_MMA(1, 1, At, B1); PG8_BAR; PG8_SCHED;
            } else {
            PG8_LDB(B0, 0, 0); PG8_SCHED; PG8_LDA(At, 0, 0); PG8_STAGE(PG8_SA(1, 1), a1 + hstep, voffA);
            PG8_WAIT_L(8); PG8_BAR; PG8_WAIT_L(0); PG8_MMA(0, 0, At, B0); PG8_BAR; PG8_SCHED;
            PG8_LDB(B1, 0, 1); PG8_STAGE(PG8_SB(0, 0), b2, voffB);
            PG8_BAR; PG8_WAIT_L(0); PG8_MMA(0, 1, At, B1); PG8_BAR;
            PG8_LDA(At, 0, 1); PG8_STAGE(PG8_SA(0, 0), a2, voffA);
            PG8_BAR; PG8_WAIT_L(0); PG8_MMA(1, 0, At, B0); PG8_BAR; PG8_SCHED;
            PG8_STAGE(PG8_SB(0, 1), b2 + hstep, voffB);
            PG8_WAIT_V(6); PG8_BAR; PG8_MMA(1, 1, At, B1); PG8_BAR;
            PG8_LDB(B0, 1, 0); PG8_SCHED; PG8_LDA(At, 1, 0); PG8_STAGE(PG8_SA(0, 1), a2 + hstep, voffA);
            PG8_WAIT_L(8); PG8_BAR; PG8_WAIT_L(0); PG8_MMA(0, 0, At, B0); PG8_BAR; PG8_SCHED;
            PG8_LDB(B1, 1, 1); PG8_STAGE(PG8_SB(1, 0), b3, voffB);
            PG8_BAR; PG8_WAIT_L(0); PG8_MMA(0, 1, At, B1); PG8_BAR;
            PG8_LDA(At, 1, 1); PG8_STAGE(PG8_SA(1, 0), a3, voffA);
            PG8_BAR; PG8_WAIT_L(0); PG8_MMA(1, 0, At, B0); PG8_BAR; PG8_SCHED;
            PG8_STAGE(PG8_SB(1, 1), b3 + hstep, voffB);
            PG8_WAIT_V(6); PG8_BAR; PG8_MMA(1, 1, At, B1); PG8_BAR;
            }
        }
        if constexpr (ALIGN_EPI) { if (wr == 0) PG8_BAR; }
        if constexpr (!Epi::AFTER_DRAIN) { E(acc, cur, wr, wc, fr, fq); S.done(cur); }
        if (!has_next) break;
#pragma unroll
        for (int a = 0; a < 2; ++a)
#pragma unroll
            for (int b = 0; b < 2; ++b)
#pragma unroll
                for (int m = 0; m < 4; ++m)
#pragma unroll
                    for (int n = 0; n < 2; ++n) acc[a][b][m][n] = (f32x4){0.f, 0.f, 0.f, 0.f};
        cur = nxt; cA = nA; cB = nB; ++ui;
        if constexpr (ALIGN_EPI) { if (wr == 1) PG8_BAR; }
    }
    PG8_WAIT_V(0);
    if constexpr (!ALIGN_EPI) { if (wr == 0) PG8_BAR; }
    PG8_BAR;
    if constexpr (Epi::AFTER_DRAIN) { E.fused(acc, cur, wr, wc, fr, fq, lds, wid, lane); S.done(cur); }
#undef PG8_SA
#undef PG8_SB
#undef PG8_STAGE
#undef PG8_LDA
#undef PG8_LDB
#undef PG8_MMA
#undef PG8_WAIT_V
#undef PG8_WAIT_L
#undef PG8_BAR
#undef PG8_SCHED
}
}
namespace att {
typedef unsigned short bf16_t;
using bf16x8 = __attribute__((ext_vector_type(8))) short;
using s16x4  = __attribute__((ext_vector_type(4))) short;
using f32x16 = __attribute__((ext_vector_type(16))) float;
using f32x4  = __attribute__((ext_vector_type(4))) float;
using u32x4  = __attribute__((ext_vector_type(4))) unsigned;
constexpr int NW = 8, QBLK = 32, KVBLK = 64, LDK = 512;
constexpr int SHM_V = KVBLK * 128 * 2, SHM_K = KVBLK * 128 * 2;
constexpr int V_OFF = 0, K_OFF = 2 * SHM_V, XCH_OFF = K_OFF + 2 * SHM_K, XROW = 132, XCH_WAVE = 32 * XROW * 4;
constexpr int WS_OFF = XCH_OFF + 4 * XCH_WAVE, TAB_OFF = WS_OFF + NW * 64 * 4, NINF_OFF = TAB_OFF + 4 * 256 * 4, ATT_END = NINF_OFF + 256;
#ifndef ATT_SDEPTH
#define ATT_SDEPTH 1
#endif
constexpr int SDEPTH = ATT_SDEPTH;
constexpr float THR = 8.f;
#define KSWZ(row, colB) ((row) * 256 + ((colB) ^ (((row) & 7) << 4)))
#define SBAR() __builtin_amdgcn_sched_barrier(0)
__device__ __forceinline__ int crow(int r, int hi) { return (r & 3) + 8 * (r >> 2) + 4 * hi; }
__device__ __forceinline__ unsigned cvtpk(float lo, float hi) { unsigned r; asm volatile("v_cvt_pk_bf16_f32 %0, %1, %2" : "=v"(r) : "v"(lo), "v"(hi)); return r; }

__device__ __forceinline__ void score_init(f32x16& p0, f32x16& p1, int t, int nvis, const float* tabq, const float* ninf) {
  if (t >= nvis - 3) {
    const float* tp = (t >= nvis) ? ninf : tabq + 64 * (t - (nvis - 1));
#pragma unroll
    for (int r = 0; r < 16; ++r) { p0[r] = tp[(r & 3) + 8 * (r >> 2)]; p1[r] = tp[32 + (r & 3) + 8 * (r >> 2)]; }
  } else { p0 = f32x16{}; p1 = f32x16{}; }
}
__device__ __forceinline__ void partialSM(f32x16& p0, f32x16& p1, float& m_reg, float& mn, float& alpha) {
  float pmax = p0[0];
#pragma unroll
  for (int r = 1; r < 16; ++r) pmax = fmaxf(pmax, p0[r]);
#pragma unroll
  for (int r = 0; r < 16; ++r) pmax = fmaxf(pmax, p1[r]);
  { auto rr = __builtin_amdgcn_permlane32_swap(__float_as_uint(pmax), __float_as_uint(pmax), false, false);
    pmax = fmaxf(__uint_as_float(rr[0]), __uint_as_float(rr[1])); }
  if (__builtin_expect(__all(pmax - m_reg <= THR), 1)) { mn = m_reg; alpha = 1.f; }
  else { mn = fmaxf(m_reg, pmax); alpha = __builtin_amdgcn_exp2f(m_reg - mn); m_reg = mn; }
#pragma unroll
  for (int r = 0; r < 16; ++r) p0[r] = p0[r] - mn;
#pragma unroll
  for (int r = 0; r < 16; ++r) p1[r] = p1[r] - mn;
#pragma unroll
  for (int r = 0; r < 16; ++r) p0[r] = __builtin_amdgcn_exp2f(p0[r]);
}
__device__ __forceinline__ void finishSM(f32x16& p0, f32x16& p1, float alpha, float& l_reg, bf16x8& pa0, bf16x8& pa1, bf16x8& pa2, bf16x8& pa3) {
#pragma unroll
  for (int r = 0; r < 16; ++r) p1[r] = __builtin_amdgcn_exp2f(p1[r]);
  float ps = 0;
#pragma unroll
  for (int r = 0; r < 16; ++r) ps += p0[r];
#pragma unroll
  for (int r = 0; r < 16; ++r) ps += p1[r];
  { auto rr = __builtin_amdgcn_permlane32_swap(__float_as_uint(ps), __float_as_uint(ps), false, false);
    ps = __uint_as_float(rr[0]) + __uint_as_float(rr[1]); }
  l_reg = l_reg * alpha + ps;
#define PK4(P, BASE, OUT) do { unsigned a0 = cvtpk(P[BASE + 0], P[BASE + 1]), a1 = cvtpk(P[BASE + 2], P[BASE + 3]);   \
    unsigned b0 = cvtpk(P[BASE + 4], P[BASE + 5]), b1 = cvtpk(P[BASE + 6], P[BASE + 7]);                              \
    auto r0 = __builtin_amdgcn_permlane32_swap(a0, b0, false, false); auto r1 = __builtin_amdgcn_permlane32_swap(a1, b1, false, false); \
    u32x4 w = {r0[0], r1[0], r0[1], r1[1]}; OUT = *reinterpret_cast<bf16x8*>(&w); } while (0)
  PK4(p0, 0, pa0); PK4(p0, 8, pa1); PK4(p1, 0, pa2); PK4(p1, 8, pa3);
#undef PK4
}
__device__ __forceinline__ void qkt(f32x16& p0, f32x16& p1, const char* Ks, const bf16x8* qr, int r32, int hi, int g, int t, int nvis, const float* tabq, const float* ninf) {
  score_init(p0, p1, t, nvis, tabq, ninf);
#pragma unroll
  for (int d0 = 0; d0 < 4; ++d0) { const int cb = (g * 64 + d0 * 16 + hi * 8) * 2;
    const bf16x8 b0 = *reinterpret_cast<const bf16x8*>(Ks + KSWZ(r32, cb));
    const bf16x8 b1 = *reinterpret_cast<const bf16x8*>(Ks + KSWZ(32 + r32, cb));
    p0 = __builtin_amdgcn_mfma_f32_32x32x16_bf16(b0, qr[d0], p0, 0, 0, 0);
    p1 = __builtin_amdgcn_mfma_f32_32x32x16_bf16(b1, qr[d0], p1, 0, 0, 0); }
}
__device__ __forceinline__ int v_st(int k, int c) { const int kk = (k & ~0xC) | ((k & 4) << 1) | ((k & 8) >> 1); return ((kk >> 3) * 4 + (c >> 5)) * 512 + ((kk & 7) * 32 + (c & 31)) * 2; }
__device__ __forceinline__ int v_rd_base(int lane) { return ((lane & 3) << 3) | (((lane >> 2) & 3) << 6) | (((lane >> 4) & 1) << 5) | (((lane >> 5) & 1) << 8); }
constexpr int v_rd_off(int d0, int ks, int half) { return d0 * 512 + ks * 4096 + half * 2048; }
template <int OFF> __device__ __forceinline__ s16x4 tr_read(int vb) {
  s16x4 r; asm volatile("ds_read_b64_tr_b16 %0, %1 offset:%2" : "=&v"(r) : "v"(vb), "i"(OFF) : "memory"); return r;
}
template <int D0> __device__ __forceinline__ void pv_one(f32x16& od, int vb, bf16x8 pa0, bf16x8 pa1, bf16x8 pa2, bf16x8 pa3) {
  const s16x4 l0 = tr_read<v_rd_off(D0, 0, 0)>(vb), h0 = tr_read<v_rd_off(D0, 0, 1)>(vb), l1 = tr_read<v_rd_off(D0, 1, 0)>(vb), h1 = tr_read<v_rd_off(D0, 1, 1)>(vb);
  const s16x4 l2 = tr_read<v_rd_off(D0, 2, 0)>(vb), h2 = tr_read<v_rd_off(D0, 2, 1)>(vb), l3 = tr_read<v_rd_off(D0, 3, 0)>(vb), h3 = tr_read<v_rd_off(D0, 3, 1)>(vb);
  asm volatile("s_waitcnt lgkmcnt(0)" ::: "memory"); SBAR();
#define PK(L, H) (bf16x8){L[0], L[1], L[2], L[3], H[0], H[1], H[2], H[3]}
  od = __builtin_amdgcn_mfma_f32_32x32x16_bf16(pa0, PK(l0, h0), od, 0, 0, 0);
  od = __builtin_amdgcn_mfma_f32_32x32x16_bf16(pa1, PK(l1, h1), od, 0, 0, 0);
  od = __builtin_amdgcn_mfma_f32_32x32x16_bf16(pa2, PK(l2, h2), od, 0, 0, 0);
  od = __builtin_amdgcn_mfma_f32_32x32x16_bf16(pa3, PK(l3, h3), od, 0, 0, 0);
#undef PK
}
__device__ __forceinline__ void pv_d0(f32x16* o, int vb, bf16x8 pa0, bf16x8 pa1, bf16x8 pa2, bf16x8 pa3) {
  pv_one<0>(o[0], vb, pa0, pa1, pa2, pa3); pv_one<1>(o[1], vb, pa0, pa1, pa2, pa3); pv_one<2>(o[2], vb, pa0, pa1, pa2, pa3); pv_one<3>(o[3], vb, pa0, pa1, pa2, pa3);
}

__device__ __forceinline__ void attn_unit(const bf16_t* __restrict__ Qb, const bf16_t* __restrict__ Kh, const bf16_t* __restrict__ Vh, bf16_t* __restrict__ Ob,
                                          int NT, int nvis_lo, int nvis_hi, int nrb, const float* tabh, float lam, const float* __restrict__ subg, char* lds) {
  const int tid = threadIdx.x, lane = tid & 63, r32 = lane & 31, hi = lane >> 5;
  const int wid = __builtin_amdgcn_readfirstlane(tid >> 6), g = wid >> 2, rb = wid & 3;
  const bool active = rb < nrb; const int rbq = active ? rb : (rb & (nrb - 1));
  const int nvis = (rb >> 1) ? nvis_hi : nvis_lo;
  char* V_lds = lds + V_OFF; char* K_lds = lds + K_OFF;
  float* ws = (float*)(lds + WS_OFF) + wid * 64; float* li_l = ws; float* al_l = ws + 32;
  const float* tabq = tabh + 191 + 4 * hi - ((rb & 1) * 32 + r32); const float* ninf = (const float*)(lds + NINF_OFF);
  float m_reg = -1e30f, l_reg = 0; f32x16 o[4] = {}; bf16x8 qr[4];
  const bf16_t* Qw = Qb + (size_t)(rbq * QBLK + r32) * LDK + g * 64 + hi * 8;
#pragma unroll
  for (int d0 = 0; d0 < 4; ++d0) qr[d0] = *reinterpret_cast<const bf16x8*>(Qw + d0 * 16);
  const int sr = tid >> 4, sc = (tid & 15) * 8, vst0 = v_st(sr, sc), vst1 = v_st(32 + sr, sc);
  const int vb0 = (int)(uintptr_t)V_lds + v_rd_base(lane);
  struct { bf16x8 vs0, vs1, ks0, ks1; } sr_[SDEPTH];
#define SLOAD(i, k0) do { sr_[i].vs0 = *reinterpret_cast<const bf16x8*>(&Vh[(size_t)((k0) + sr) * LDK + sc]); sr_[i].vs1 = *reinterpret_cast<const bf16x8*>(&Vh[(size_t)((k0) + 32 + sr) * LDK + sc]); \
    sr_[i].ks0 = *reinterpret_cast<const bf16x8*>(&Kh[(size_t)((k0) + sr) * LDK + sc]); sr_[i].ks1 = *reinterpret_cast<const bf16x8*>(&Kh[(size_t)((k0) + 32 + sr) * LDK + sc]); } while (0)
#define SWRITE(b, i) do { *(bf16x8*)(V_lds + (b) * SHM_V + vst0) = sr_[i].vs0; *(bf16x8*)(V_lds + (b) * SHM_V + vst1) = sr_[i].vs1; const int kc = sc * 2; \
    *(bf16x8*)(K_lds + (b) * SHM_K + KSWZ(sr, kc)) = sr_[i].ks0; *(bf16x8*)(K_lds + (b) * SHM_K + KSWZ(32 + sr, kc)) = sr_[i].ks1; } while (0)
#define SWAIT() do { if constexpr (SDEPTH == 2) asm volatile("s_waitcnt vmcnt(4)" ::: "memory"); else asm volatile("s_waitcnt vmcnt(0)" ::: "memory"); } while (0)
#define RESC(a) do { if (__any((a) < 1.f)) { if (hi == 0) al_l[r32] = (a); asm volatile("s_waitcnt lgkmcnt(0)" ::: "memory"); \
    _Pragma("unroll") for (int d = 0; d < 4; ++d) _Pragma("unroll") for (int r = 0; r < 16; ++r) o[d][r] *= al_l[crow(r, hi)]; } } while (0)
  f32x16 pA0, pA1, pB0, pB1; float mnA, mnB, alA, alB; bf16x8 pa0, pa1, pa2, pa3;
  constexpr int SE = 0, SO = SDEPTH - 1;
  SLOAD(SE, 0); asm volatile("s_waitcnt vmcnt(0)" ::: "memory"); SWRITE(0, SE); __syncthreads();
  qkt(pA0, pA1, K_lds, qr, r32, hi, g, 0, nvis, tabq, ninf); partialSM(pA0, pA1, m_reg, mnA, alA);
  SLOAD(SO, KVBLK); if constexpr (SDEPTH == 2) { if (2 < NT) SLOAD(SE, 2 * KVBLK); }
  SWAIT(); SWRITE(1, SO); __syncthreads();
  for (int j = 1; j + 1 < NT; j += 2) {
    SBAR(); qkt(pB0, pB1, K_lds + SHM_K, qr, r32, hi, g, j, nvis, tabq, ninf);
    finishSM(pA0, pA1, alA, l_reg, pa0, pa1, pa2, pa3); SBAR();
    SLOAD(SO, (j + SDEPTH) * KVBLK); SBAR();
    pv_d0(o, vb0, pa0, pa1, pa2, pa3); partialSM(pB0, pB1, m_reg, mnB, alB);
    __syncthreads(); SWAIT(); SWRITE(0, SE);
    RESC(alB); __syncthreads();
    SBAR(); qkt(pA0, pA1, K_lds, qr, r32, hi, g, j + 1, nvis, tabq, ninf);
    finishSM(pB0, pB1, alB, l_reg, pa0, pa1, pa2, pa3); SBAR();
    if (SDEPTH == 1 || j + 3 < NT) SLOAD(SE, (j + 1 + SDEPTH) * KVBLK); SBAR();
    pv_d0(o, vb0 + SHM_V, pa0, pa1, pa2, pa3); partialSM(pA0, pA1, m_reg, mnA, alA);
    __syncthreads(); SWAIT(); SWRITE(1, SO);
    RESC(alA); __syncthreads();
  }
  SBAR(); qkt(pB0, pB1, K_lds + SHM_K, qr, r32, hi, g, NT - 1, nvis, tabq, ninf);
  finishSM(pA0, pA1, alA, l_reg, pa0, pa1, pa2, pa3); SBAR();
  pv_d0(o, vb0, pa0, pa1, pa2, pa3); partialSM(pB0, pB1, m_reg, mnB, alB);
  __syncthreads(); RESC(alB);
  finishSM(pB0, pB1, alB, l_reg, pa0, pa1, pa2, pa3); SBAR();
  pv_d0(o, vb0 + SHM_V, pa0, pa1, pa2, pa3);
  if (hi == 0) li_l[r32] = l_reg; asm volatile("s_waitcnt lgkmcnt(0)" ::: "memory");
  float rli[16];
#pragma unroll
  for (int r = 0; r < 16; ++r) rli[r] = __builtin_amdgcn_rcpf(li_l[crow(r, hi)]);
  float* X = (float*)(lds + XCH_OFF + rb * XCH_WAVE);
  if (g == 1) {
#pragma unroll
    for (int r = 0; r < 16; ++r) { const float f = rli[r] * lam; const int q = crow(r, hi);
#pragma unroll
      for (int d0 = 0; d0 < 4; ++d0) X[q * XROW + d0 * 32 + r32] = o[d0][r] * f; }
  }
  __syncthreads();
  if (g == 0) {
#pragma unroll
    for (int r = 0; r < 16; ++r) { const int q = crow(r, hi);
#pragma unroll
      for (int d0 = 0; d0 < 4; ++d0) { float* xp = &X[q * XROW + d0 * 32 + r32]; *xp = o[d0][r] * rli[r] - *xp; } }
    asm volatile("s_waitcnt lgkmcnt(0)" ::: "memory");
    const float* xr = X + r32 * XROW + hi * 64;
    float ss = 0.f;
#pragma unroll
    for (int i = 0; i < 16; ++i) { const f32x4 v = *(const f32x4*)(xr + 4 * i); ss += (v[0] * v[0] + v[1] * v[1]) + (v[2] * v[2] + v[3] * v[3]); }
    { auto rr = __builtin_amdgcn_permlane32_swap(__float_as_uint(ss), __float_as_uint(ss), false, false); ss = __uint_as_float(rr[0]) + __uint_as_float(rr[1]); }
    const float rs = (1.f - LAM_INIT) / sqrtf(ss * (1.f / 128.f) + SUBLN_EPS);
    if (active) {
      bf16_t* op = Ob + (size_t)(rb * QBLK + r32) * 1024 + hi * 64;
#pragma unroll
      for (int i = 0; i < 8; ++i) { const f32x4 v0 = *(const f32x4*)(xr + 8 * i), v1 = *(const f32x4*)(xr + 8 * i + 4);
        const f32x4 g0 = *(const f32x4*)(subg + hi * 64 + 8 * i), g1 = *(const f32x4*)(subg + hi * 64 + 8 * i + 4);
        u32x4 w; w.x = cvtpk(v0[0] * rs * g0[0], v0[1] * rs * g0[1]); w.y = cvtpk(v0[2] * rs * g0[2], v0[3] * rs * g0[3]);
        w.z = cvtpk(v1[0] * rs * g1[0], v1[1] * rs * g1[1]); w.w = cvtpk(v1[2] * rs * g1[2], v1[3] * rs * g1[3]);
        *(u32x4*)(op + 8 * i) = w; }
    }
  }
  __syncthreads();
#undef SLOAD
#undef SWRITE
#undef SWAIT
#undef RESC
}
#undef SBAR
}
#define GAS __attribute__((address_space(1)))
#define LAS __attribute__((address_space(3)))
typedef unsigned short bf16;
typedef unsigned v4u __attribute__((ext_vector_type(4)));
typedef float f32x4 __attribute__((ext_vector_type(4)));
typedef short bf16x8 __attribute__((ext_vector_type(8)));
typedef GAS unsigned gu32;
typedef GAS unsigned long long gu64;
#define RLX_AGENT __ATOMIC_RELAXED, __HIP_MEMORY_SCOPE_AGENT
#define LDS_WAIT() asm volatile("s_waitcnt lgkmcnt(0)" ::: "memory")
#define VM_WAIT() asm volatile("s_waitcnt vmcnt(0)" ::: "memory")
__device__ __forceinline__ unsigned long long rt() { return __builtin_amdgcn_s_memrealtime(); }
__device__ __forceinline__ unsigned f2bf(float f) { unsigned u = __builtin_bit_cast(unsigned, f); return (u + 0x7fffu + ((u >> 16) & 1u)) >> 16; }
__device__ __forceinline__ unsigned pk2(float lo, float hi) { return f2bf(lo) | (f2bf(hi) << 16); }

#define XB_TMO      128
#define XB_XCNT(j)  (256  + 64 * (j))
#define XB_XSUB(j)  (1280 + 64 * (j))
#define XB_XGEN(j)  (2304 + 64 * (j))
#define XB_TOP      3328
#define XB_TOPGEN   3392
#define XCD_BAR_WORDS 3456
#define XB_SPIN_CAP (1u << 18)

__device__ __forceinline__ unsigned xb_ld(unsigned* p)              { return __hip_atomic_load(p, __ATOMIC_RELAXED, __HIP_MEMORY_SCOPE_AGENT); }
__device__ __forceinline__ unsigned xb_add(unsigned* p, unsigned v) { return __hip_atomic_fetch_add(p, v, __ATOMIC_RELAXED, __HIP_MEMORY_SCOPE_AGENT); }
__device__ __forceinline__ unsigned xb_xcc_id() { return (unsigned)__builtin_amdgcn_s_getreg((3 << 11) | 20) & 0xFu; }
#define XB_SPIN(cond, bar) do { unsigned _sp = 0; while (cond) { __builtin_amdgcn_s_sleep(1); \
    if ((++_sp & 255u) == 0u) { if (xb_ld(&(bar)[XB_TMO])) break; if (_sp > XB_SPIN_CAP) { atomicAdd(&(bar)[XB_TMO], 1u); break; } } } } while (0)

struct XcdBarrier {
    unsigned* bar; unsigned x;
    volatile LAS unsigned* st;
};

__device__ __forceinline__ XcdBarrier xcd_barrier_post(unsigned* bar, volatile LAS unsigned* st) {
    XcdBarrier b; b.bar = bar; b.x = xb_xcc_id(); b.st = st;
    if (threadIdx.x == 0) (void)xb_add(&bar[XB_XCNT(b.x)], 1u);
    return b;
}
__device__ __forceinline__ void xcd_barrier_complete(unsigned* bar, unsigned x, unsigned& nloc, unsigned& nx) {
    const unsigned G = gridDim.x * gridDim.y * gridDim.z;
    unsigned sum, cnt, mine, sp = 0u;
    for (;;) {
        sum = 0u; cnt = 0u; mine = 0u;
#pragma unroll
        for (unsigned j = 0; j < 16; ++j) { const unsigned c = xb_ld(&bar[XB_XCNT(j)]); sum += c; cnt += (c > 0u) ? 1u : 0u; mine = (j == x) ? c : mine; }
        if (sum == G) break;
        __builtin_amdgcn_s_sleep(1);
        if ((++sp & 255u) == 0u) { if (xb_ld(&bar[XB_TMO])) break; if (sp > XB_SPIN_CAP) { atomicAdd(&bar[XB_TMO], 1u); break; } }
    }
    nloc = mine > 0u ? mine : 1u; nx = cnt > 0u ? cnt : 1u;
}

__device__ __forceinline__ void xcd_barrier(const XcdBarrier& b) {
    asm volatile("s_waitcnt vmcnt(0)" ::: "memory");
    __syncthreads();
    if (threadIdx.x == 0) {
        unsigned* bar = b.bar;
        __builtin_amdgcn_s_waitcnt(0);
        unsigned nloc = b.st[0], nx = b.st[1];
        if (nloc == 0u) { xcd_barrier_complete(bar, b.x, nloc, nx); b.st[0] = nloc; b.st[1] = nx; }
        const unsigned old = xb_add(&bar[XB_XSUB(b.x)], 1u);
        const unsigned gen = old / nloc;
        if (old + 1u == (gen + 1u) * nloc) {
            __builtin_amdgcn_fence(__ATOMIC_RELEASE, "agent");
            asm volatile("s_waitcnt vmcnt(0)" ::: "memory");
            const unsigned og = xb_add(&bar[XB_TOP], 1u);
            const unsigned tg = og / nx;
            if (og + 1u == (tg + 1u) * nx) xb_add(&bar[XB_TOPGEN], 1u);
            else XB_SPIN(xb_ld(&bar[XB_TOPGEN]) == tg, bar);
            __builtin_amdgcn_fence(__ATOMIC_ACQUIRE, "agent");
            xb_add(&bar[XB_XGEN(b.x)], 1u);
            asm volatile("s_waitcnt vmcnt(0)" ::: "memory");
        } else {
            XB_SPIN(xb_ld(&bar[XB_XGEN(b.x)]) == gen, bar);
            __builtin_amdgcn_fence(__ATOMIC_ACQUIRE, "agent");
            asm volatile("s_waitcnt vmcnt(0)" ::: "memory");
        }
    }
    __syncthreads();
}
constexpr int NWAVES = 8;
constexpr int N_LAUNCHES = MK_N_LAUNCHES;
constexpr int PER_PHASE = 8;
static_assert(N_LAUNCHES == 1 || N_LAUNCHES == PER_PHASE, "MK_N_LAUNCHES is 1 or 8");

constexpr size_t MiB = 1u << 20;
constexpr size_t WS_CTL = 0, CTL_ZERO_BYTES = 1 * MiB;
constexpr size_t WS_WIN = 2 * MiB, WS_WOUT = 8 * MiB, WS_W1 = 10 * MiB, WS_W2 = 18 * MiB;
constexpr size_t WS_STATS = 26 * MiB;
constexpr size_t WS_XN = 32 * MiB;
constexpr size_t WS_QB = 98 * MiB, WS_KB = 131 * MiB, WS_VB = 197 * MiB, WS_GB = 263 * MiB, WS_UB = 296 * MiB, WS_MIX = 329 * MiB;
constexpr size_t WS_H = 98 * MiB;
constexpr size_t WS_END = 395 * MiB;
static_assert(WS_XN + (size_t)M * DM * 2 <= WS_QB && WS_QB + (size_t)M * 512 * 2 <= WS_KB && WS_KB + (size_t)NKV_ROWS * 512 * 2 <= WS_VB && WS_VB + (size_t)NKV_ROWS * 512 * 2 <= WS_GB &&
              WS_GB + (size_t)M * 512 * 2 <= WS_UB && WS_UB + (size_t)M * 512 * 2 <= WS_MIX && WS_MIX + (size_t)M * DM * 2 <= WS_END && WS_H + (size_t)M * DFF * 2 <= WS_END &&
              WS_STATS + (size_t)M * 8 <= WS_XN && WS_W2 + (size_t)DM * DFF * 2 <= WS_STATS, "d_ws map");
constexpr int CW_BAR = 4096;

constexpr int RING_OFF = 0, RING_BYTES = 131072;
constexpr int LDSCTL_OFF = 139520, MISC_OFF = LDSCTL_OFF + 320;
constexpr int LDS_BYTES = 147456;
static_assert(att::ATT_END <= LDSCTL_OFF && MISC_OFF + 128 <= LDS_BYTES, "LDS map");


struct Frame {
    LAS unsigned char* lds;
    volatile LAS unsigned* MISC;
    gu32* ctl;
    int tid, lane, wave;
    int vcu, G;
};

__device__ __forceinline__ float wave_sum(float v) {
#pragma unroll
    for (int o = 1; o < 64; o <<= 1) v += __shfl_xor(v, o);
    return v;
}
__device__ __forceinline__ void p0_transpose_item(const float* W, int K, int N, bf16* WT, int k0, int n0, int dst_row0, LAS float* scr, int lane) {
#pragma unroll 8
    for (int i = 0; i < 32; ++i) { const int kk = 2 * i + (lane >> 5); scr[kk * 33 + (lane & 31)] = W[(size_t)(k0 + kk) * N + n0 + (lane & 31)]; }
    LDS_WAIT(); asm volatile("" ::: "memory");
    const int c = lane & 7;
#pragma unroll
    for (int j = 0; j < 4; ++j) { const int n = (lane >> 3) + 8 * j; const LAS float* s = scr + (8 * c) * 33 + n;
        v4u o; o.x = pk2(s[0 * 33], s[1 * 33]); o.y = pk2(s[2 * 33], s[3 * 33]); o.z = pk2(s[4 * 33], s[5 * 33]); o.w = pk2(s[6 * 33], s[7 * 33]);
        *(GAS v4u*)(WT + (size_t)(dst_row0 + n) * K + k0 + 8 * c) = o; }
    LDS_WAIT(); asm volatile("" ::: "memory");
}
__device__ __forceinline__ int win_dst(int n0) {
    if (n0 < 2048) return n0;
    if (n0 < 2560) { const int c = n0 - 2048; return 2048 + (c >> 7) * 256 + (c & 127); }
    const int c = n0 - 2560; return 2048 + (c >> 7) * 256 + 128 + (c & 127);
}
__device__ __forceinline__ void ln_row(const float* xrow, const f32x4 (&gv)[4], const f32x4 (&bv)[4], float* orow32, bf16* orow16, float* st, int lane) {
    const GAS f32x4* xr = (const GAS f32x4*)xrow + lane;
    f32x4 v[4]; float s = 0.f;
#pragma unroll
    for (int j = 0; j < 4; ++j) { v[j] = xr[64 * j]; s += (v[j].x + v[j].y) + (v[j].z + v[j].w); }
    const float mean = wave_sum(s) * (1.f / DM); float s2 = 0.f;
#pragma unroll
    for (int j = 0; j < 4; ++j) { v[j] = v[j] - mean; s2 += (v[j].x * v[j].x + v[j].y * v[j].y) + (v[j].z * v[j].z + v[j].w * v[j].w); }
    const float rstd = 1.f / sqrtf(wave_sum(s2) * (1.f / DM) + LN_EPS);
    if (st && lane == 0) { st[0] = mean; st[1] = rstd; }
#pragma unroll
    for (int j = 0; j < 4; ++j) { v[j] = v[j] * rstd * gv[j] + bv[j]; }
    if (orow32) { GAS f32x4* o4 = (GAS f32x4*)orow32 + lane;
#pragma unroll
        for (int j = 0; j < 4; ++j) o4[64 * j] = v[j]; }
    if (orow16) { GAS unsigned long long* o8 = (GAS unsigned long long*)orow16 + lane;
#pragma unroll
        for (int j = 0; j < 4; ++j) o8[64 * j] = (unsigned long long)pk2(v[j].x, v[j].y) | ((unsigned long long)pk2(v[j].z, v[j].w) << 32); }
}
__device__ __forceinline__ void load_gb(const float* g, const float* b, f32x4 (&gv)[4], f32x4 (&bv)[4], int lane) {
#pragma unroll
    for (int j = 0; j < 4; ++j) { gv[j] = *((const f32x4*)g + lane + 64 * j); bv[j] = *((const f32x4*)b + lane + 64 * j); }
}
__device__ __forceinline__ int rel_bucket(int rel) {
    const int n = rel < 0 ? -rel : rel; const int ret = rel > 0 ? 16 : 0;
    if (n < 8) return ret + n;
    int large = 8 + (31 - __builtin_clz((unsigned)(n * n))) - 6; if (large > 15) large = 15;
    return ret + large;
}

constexpr int PTR_OFF = LDSCTL_OFF + 1024;
__device__ __forceinline__ const void* ldptr(LAS unsigned char* l, int k) {
    volatile LAS unsigned* p = (volatile LAS unsigned*)(l + PTR_OFF) + 2 * k; unsigned lo = p[0], hi = p[1];
    lo = __builtin_amdgcn_readfirstlane(lo); hi = __builtin_amdgcn_readfirstlane(hi); return (const void*)(uintptr_t)(((unsigned long long)hi << 32) | lo);
}
struct Args { const float* in[22]; float* out; unsigned char* ws; int ph_lo, ph_hi, li, pad; };

__global__ void __launch_bounds__(NWAVES * 64, 2) skel_fwd(Args args) {
    extern __shared__ __attribute__((aligned(16))) unsigned char lds[];
    Frame F;
    F.lds = (LAS unsigned char*)lds;
    F.MISC = (volatile LAS unsigned*)(F.lds + MISC_OFF);
    F.tid = threadIdx.x; F.lane = F.tid & 63; F.wave = __builtin_amdgcn_readfirstlane(F.tid >> 6);
    F.G = gridDim.x; { const int bx = blockIdx.x; F.vcu = (F.G % 8 == 0) ? (bx % 8) * (F.G / 8) + bx / 8 : bx; }
    unsigned char* ws = args.ws;
    F.ctl = (gu32*)(ws + WS_CTL);
    float* out = args.out;
    bf16* WIN_T = (bf16*)(ws + WS_WIN); bf16* WOUT_T = (bf16*)(ws + WS_WOUT); bf16* W1_T = (bf16*)(ws + WS_W1); bf16* W2_T = (bf16*)(ws + WS_W2);
    float* STATS = (float*)(ws + WS_STATS);
    bf16* XN = (bf16*)(ws + WS_XN); bf16* QB = (bf16*)(ws + WS_QB); bf16* KB = (bf16*)(ws + WS_KB); bf16* VB = (bf16*)(ws + WS_VB);
    bf16* GBUF = (bf16*)(ws + WS_GB); bf16* UB = (bf16*)(ws + WS_UB); bf16* MIX = (bf16*)(ws + WS_MIX); bf16* HB = (bf16*)(ws + WS_H);
    float* Y = out + O_Y;

    for (int u = F.tid; u < (LDS_BYTES - LDSCTL_OFF) / 4; u += NWAVES * 64) ((LAS unsigned*)(F.lds + LDSCTL_OFF))[u] = 0u;
    __syncthreads();
    if (F.tid == 0) { LAS unsigned long long* PT = (LAS unsigned long long*)(F.lds + PTR_OFF);
#pragma unroll
        for (int k = 0; k < 22; ++k) PT[k] = (unsigned long long)(uintptr_t)args.in[k]; }
    __syncthreads();
#define INP(k) ((const float*)ldptr(F.lds, (k)))
    const float* rel_bias = INP(7);
    { float* tab = (float*)(lds + att::TAB_OFF);
      for (int e = F.tid; e < 4 * 256; e += NWAVES * 64) { const int h = e >> 8, i = e & 255; const int rel = i - 191;
          tab[e] = (rel_bias[rel_bucket(rel) * 4 + h] - rel_bias[15 * 4 + h]) * 1.4426950408889634f; }
      if (F.tid < 64) ((float*)(lds + att::NINF_OFF))[F.tid] = -INFINITY; }
    __syncthreads();
    const int bli = 0;
    XcdBarrier bar; bar.bar = (unsigned*)(F.ctl + CW_BAR) + bli * XCD_BAR_WORDS; bar.x = 0; bar.st = nullptr;
    if (N_LAUNCHES != PER_PHASE) bar = xcd_barrier_post((unsigned*)(F.ctl + CW_BAR) + bli * XCD_BAR_WORDS, F.MISC + 8);
#define GRID_BAR() do { if (N_LAUNCHES != PER_PHASE) xcd_barrier(bar); } while (0)
    const int lo = args.ph_lo, hi = args.ph_hi;
#ifndef PH_MASK
#define PH_MASK 0xff
#endif
#define IN(k) (((PH_MASK >> (k)) & 1) && lo <= (k) && (k) < hi)
#define BOTH(k) (IN(k) && IN((k) + 1))
    const int gw = F.vcu * NWAVES + F.wave, NGW = F.G * NWAVES;

    if (IN(0)) {
        const float* x_prompt = INP(0); const float* x_sample = INP(1); const float* cache_k = INP(2); const float* cache_v = INP(3); const float* ln0_g = INP(5); const float* ln0_b = INP(6);
        const float* w_in = INP(8); const float* w_out = INP(15); const float* w_ff1 = INP(18); const float* w_ff2 = INP(19);
        LAS float* scr = (LAS float*)(F.lds + RING_OFF + F.wave * 16384);
        constexpr int I_IN = (DM / 64) * (NIN / 32), I_OUT = (DM / 64) * (DM / 32), I_1 = (DM / 64) * (DFF / 32), I_2 = (DFF / 64) * (DM / 32);
        constexpr int NITEMS = I_IN + I_OUT + I_1 + I_2;
        for (int it = gw; it < NITEMS; it += NGW) {
            int r = it;
            if (r < I_IN) { const int nblk = NIN / 32, kb = r / nblk, nb = r % nblk; p0_transpose_item(w_in, DM, NIN, WIN_T, 64 * kb, 32 * nb, win_dst(32 * nb), scr, F.lane); continue; } r -= I_IN;
            if (r < I_OUT) { const int nblk = DM / 32, kb = r / nblk, nb = r % nblk; p0_transpose_item(w_out, DM, DM, WOUT_T, 64 * kb, 32 * nb, 32 * nb, scr, F.lane); continue; } r -= I_OUT;
            if (r < I_1) { const int nblk = DFF / 32, kb = r / nblk, nb = r % nblk; p0_transpose_item(w_ff1, DM, DFF, W1_T, 64 * kb, 32 * nb, 32 * nb, scr, F.lane); continue; } r -= I_1;
            { const int nblk = DM / 32, kb = r / nblk, nb = r % nblk; p0_transpose_item(w_ff2, DFF, DM, W2_T, 64 * kb, 32 * nb, 32 * nb, scr, F.lane); }
        }
        { f32x4 gv[4], bv[4]; load_gb(ln0_g, ln0_b, gv, bv, F.lane);
          for (int m = gw; m < M; m += NGW) { const float* xr = m < NPROMPT ? x_prompt + (size_t)m * DM : x_sample + (size_t)(m - NPROMPT) * DM;
              ln_row(xr, gv, bv, nullptr, XN + (size_t)m * DM, STATS + 2 * m, F.lane); } }
        { const int gt = F.vcu * (NWAVES * 64) + F.tid, NGT = F.G * NWAVES * 64; constexpr int N8 = 16 * PAST * 64;
          for (int i = gt; i < 2 * N8; i += NGT) { const bool isv = i >= N8; const int j = isv ? i - N8 : i; const int rowc = j >> 6, c8 = (j & 63) * 8;
              const float* src = (isv ? cache_v : cache_k) + (size_t)rowc * 512 + c8; const f32x4 a = *(const f32x4*)src, b = *(const f32x4*)(src + 4);
              v4u o; o.x = pk2(a.x, a.y); o.y = pk2(a.z, a.w); o.z = pk2(b.x, b.y); o.w = pk2(b.z, b.w);
              bf16* dst = (isv ? VB : KB) + (size_t)(NPROMPT + (rowc >> 11) * KVS_ROWS + (rowc & 2047)) * 512 + c8; *(GAS v4u*)dst = o; }
          constexpr int P8 = 16 * 64 * 64;
          for (int i = gt; i < 2 * P8; i += NGT) { const bool isv = i >= P8; const int j = isv ? i - P8 : i; const int rowp = j >> 6, c8 = (j & 63) * 8;
              bf16* dst = (isv ? VB : KB) + (size_t)(NPROMPT + (rowp >> 6) * KVS_ROWS + PAST + DSEQ + (rowp & 63)) * 512 + c8; *(GAS v4u*)dst = (v4u){0u, 0u, 0u, 0u}; } }
        if (BOTH(0)) GRID_BAR();
    }

    if (IN(1)) {
        pg8::Gemm g{XN, WIN_T, M, NIN, DM}; pg8::StaticOrder S; S.init(M, NIN, F.G, (int)blockIdx.x);
        pg8::EpiIn E{QB, KB, VB, GBUF, UB, out};
        pg8::gemm_phase<pg8::EpiIn, pg8::StaticOrder, true, true>(F.lds + RING_OFF, g, S, E);
        if (BOTH(1)) GRID_BAR();
    }

    if (IN(2)) {
        const float* cache_conv = INP(4); const float* conv_w = INP(9); const float* subln_g = INP(14);
        {
            const int rsub = F.tid >> 6, c8 = (F.tid & 63) * 8;
            float w0[8], w1[8], w2[8];
#pragma unroll
            for (int i = 0; i < 8; ++i) { w0[i] = conv_w[c8 + i]; w1[i] = conv_w[512 + c8 + i]; w2[i] = conv_w[1024 + c8 + i]; }
            const int rbeg = F.vcu * (M / 256);
            for (int rr = rsub; rr < M / 256; rr += 8) {
                const int m = rbeg + rr; const bool samp = m >= NPROMPT; const int t = samp ? ((m - NPROMPT) & 63) : (m & (SEQ - 1));
                float u0[8], u1[8], u2[8], gbv[8];
                { const v4u a = *(const GAS v4u*)(UB + (size_t)m * 512 + c8); const v4u gq = *(const GAS v4u*)(GBUF + (size_t)m * 512 + c8);
                  const unsigned aw[4] = {a.x, a.y, a.z, a.w}, gwv[4] = {gq.x, gq.y, gq.z, gq.w};
#pragma unroll
                  for (int i = 0; i < 4; ++i) { u2[2 * i] = __uint_as_float(aw[i] << 16); u2[2 * i + 1] = __uint_as_float(aw[i] & 0xffff0000u); gbv[2 * i] = __uint_as_float(gwv[i] << 16); gbv[2 * i + 1] = __uint_as_float(gwv[i] & 0xffff0000u); } }
                if (t >= 1) { const v4u a = *(const GAS v4u*)(UB + (size_t)(m - 1) * 512 + c8); const unsigned aw[4] = {a.x, a.y, a.z, a.w};
#pragma unroll
                    for (int i = 0; i < 4; ++i) { u1[2 * i] = __uint_as_float(aw[i] << 16); u1[2 * i + 1] = __uint_as_float(aw[i] & 0xffff0000u); } }
                else if (samp) { const float* cp = cache_conv + (size_t)(((m - NPROMPT) >> 6) * 2 + 1) * 512 + c8;
#pragma unroll
                    for (int i = 0; i < 8; ++i) u1[i] = cp[i]; }
                else {
#pragma unroll
                    for (int i = 0; i < 8; ++i) u1[i] = 0.f; }
                if (t >= 2) { const v4u a = *(const GAS v4u*)(UB + (size_t)(m - 2) * 512 + c8); const unsigned aw[4] = {a.x, a.y, a.z, a.w};
#pragma unroll
                    for (int i = 0; i < 4; ++i) { u0[2 * i] = __uint_as_float(aw[i] << 16); u0[2 * i + 1] = __uint_as_float(aw[i] & 0xffff0000u); } }
                else if (samp) { const float* cp = cache_conv + (size_t)(((m - NPROMPT) >> 6) * 2 + t) * 512 + c8;
#pragma unroll
                    for (int i = 0; i < 8; ++i) u0[i] = cp[i]; }
                else {
#pragma unroll
                    for (int i = 0; i < 8; ++i) u0[i] = 0.f; }
                float r[8];
#pragma unroll
                for (int i = 0; i < 8; ++i) r[i] = gbv[i] * (w0[i] * u0[i] + w1[i] * u1[i] + w2[i] * u2[i]);
                v4u o; o.x = pk2(r[0], r[1]); o.y = pk2(r[2], r[3]); o.z = pk2(r[4], r[5]); o.w = pk2(r[6], r[7]);
                *(GAS v4u*)(MIX + (size_t)m * DM + 512 + c8) = o;
            }
        }
        {
            const float* tab = (const float*)(lds + att::TAB_OFF);
            float lam;
            { const float* lq1 = INP(10); const float* lk1 = INP(11); const float* lq2 = INP(12); const float* lk2 = INP(13);
              const float a = lq1[F.lane] * lk1[F.lane], b = lq2[F.lane] * lk2[F.lane]; lam = expf(wave_sum(a)) - expf(wave_sum(b)) + LAM_INIT; }

            if (F.G == 256) {
                const int bh = F.vcu >> 4, b = bh >> 2, h = bh & 3, s = F.vcu & 15;
                for (int i = 0; i < 4; ++i) { const int qb = (i == 0) ? s : (i == 1) ? 31 - s : (i == 2) ? 32 + s : 63 - s;
                    const size_t row0 = (size_t)b * SEQ + (size_t)qb * 128;
                    att::attn_unit(QB + row0 * 512 + h * 128, KB + (size_t)b * SEQ * 512 + h * 128, VB + (size_t)b * SEQ * 512 + h * 128, MIX + row0 * DM + h * 128,
                                   2 * qb + 2, 2 * qb + 1, 2 * qb + 2, 4, tab + h * 256, lam, subln_g, (char*)lds); }
                if ((F.vcu & 3) == 0) { const int su = F.vcu >> 2, sb = su >> 2, sh = su & 3;
                    const size_t row0 = (size_t)NPROMPT + (size_t)sb * DSEQ, kv0 = (size_t)NPROMPT + (size_t)sb * KVS_ROWS;
                    att::attn_unit(QB + row0 * 512 + sh * 128, KB + kv0 * 512 + sh * 128, VB + kv0 * 512 + sh * 128, MIX + row0 * DM + sh * 128,
                                   34, 33, 33, 2, tab + sh * 256, lam, subln_g, (char*)lds); }
            }
        }
        if (BOTH(2)) GRID_BAR();
    }

    if (IN(3)) {
        pg8::Gemm g{MIX, WOUT_T, M, DM, DM}; pg8::StaticOrder S; S.init(M, DM, F.G, (int)blockIdx.x);
        pg8::EpiOut E{INP(0), INP(1), STATS, INP(5), INP(6), Y};
        pg8::gemm_phase<pg8::EpiOut, pg8::StaticOrder, true, true>(F.lds + RING_OFF, g, S, E);
        if (BOTH(3)) GRID_BAR();
    }
    if (IN(4)) {
        f32x4 gv[4], bv[4]; load_gb(INP(16), INP(17), gv, bv, F.lane);
        for (int m = gw; m < M; m += NGW) ln_row(Y + (size_t)m * DM, gv, bv, Y + (size_t)m * DM, XN + (size_t)m * DM, nullptr, F.lane);
        if (BOTH(4)) GRID_BAR();
    }
    if (IN(5)) {
        pg8::Gemm g{XN, W1_T, M, DFF, DM}; pg8::StaticOrder S; S.init(M, DFF, F.G, (int)blockIdx.x);
        pg8::EpiRelu2 E{HB, DFF};
        pg8::gemm_phase<pg8::EpiRelu2, pg8::StaticOrder, true, true>(F.lds + RING_OFF, g, S, E);
        if (BOTH(5)) GRID_BAR();
    }
    if (IN(6)) {
        pg8::Gemm g{HB, W2_T, M, DM, DFF}; pg8::StaticOrder S; S.init(M, DM, F.G, (int)blockIdx.x);
        pg8::EpiDown E{Y};
        pg8::gemm_phase<pg8::EpiDown, pg8::StaticOrder, true, true>(F.lds + RING_OFF, g, S, E);
        if (BOTH(6)) GRID_BAR();
    }
    if (IN(7)) {
        f32x4 gv[4], bv[4]; load_gb(INP(20), INP(21), gv, bv, F.lane);
        for (int m = gw; m < M; m += NGW) ln_row(Y + (size_t)m * DM, gv, bv, Y + (size_t)m * DM, nullptr, nullptr, F.lane);
    }
#undef IN
#undef BOTH
#undef GRID_BAR
}

extern "C" void kernel_launch(void* const* d_in, const int* in_sizes, int n_in, void* d_out, int out_size, void* d_ws, size_t ws_size, hipStream_t stream) {
    static int grid = 0;
    if (grid == 0) {
        if (n_in != 22 || in_sizes[0] != NPROMPT * DM || out_size != 69226496 || ws_size < WS_END) {
            fprintf(stderr, "kernel_launch: shape mismatch n_in %d in0 %d out %d ws %zu (need >= %zu)\n", n_in, n_in > 0 ? in_sizes[0] : -1, out_size, ws_size, (size_t)WS_END); grid = -1; return; }
        int dev = 0, cus = 0, per_cu = 0;
        if (hipGetDevice(&dev) != hipSuccess || hipDeviceGetAttribute(&cus, hipDeviceAttributeMultiprocessorCount, dev) != hipSuccess) { grid = -1; return; }
        if (hipFuncSetAttribute((const void*)skel_fwd, hipFuncAttributeMaxDynamicSharedMemorySize, LDS_BYTES) != hipSuccess) { fprintf(stderr, "kernel_launch: hipFuncSetAttribute failed\n"); grid = -1; return; }
        if (hipOccupancyMaxActiveBlocksPerMultiprocessor(&per_cu, (const void*)skel_fwd, NWAVES * 64, LDS_BYTES) != hipSuccess || per_cu < 1)
            fprintf(stderr, "kernel_launch: note: occupancy query reports %d workgroups per CU\n", per_cu);
        (void)hipGetLastError();
        grid = cus;
        if (grid != 256) fprintf(stderr, "kernel_launch: %d CUs; this kernel is built for 256\n", grid);
    }
    if (grid < 0) return;
    if (hipMemsetAsync((char*)d_ws + WS_CTL, 0, CTL_ZERO_BYTES, stream) != hipSuccess) { fprintf(stderr, "kernel_launch: hipMemsetAsync failed\n"); return; }
    Args a{};
    for (int i = 0; i < 22; ++i) a.in[i] = (const float*)d_in[i];
    a.out = (float*)d_out; a.ws = (unsigned char*)d_ws;
    for (int li = 0; li < N_LAUNCHES; ++li) {
        a.ph_lo = (N_LAUNCHES == PER_PHASE) ? li : 0; a.ph_hi = (N_LAUNCHES == PER_PHASE) ? li + 1 : PER_PHASE; a.li = li;
        hipLaunchKernelGGL(skel_fwd, dim3(grid), dim3(NWAVES * 64), LDS_BYTES, stream, a);
        const hipError_t le = hipPeekAtLastError();
        if (le != hipSuccess) { fprintf(stderr, "kernel_launch: launch %d failed: %s\n", li, hipGetErrorName(le)); break; }
    }
}
```
